# Optimizing an MI355X kernel written in HIP

```python
import math
import jax, jax.numpy as jnp
from jax import lax
import numpy as np

D_MODEL = 1024
BATCH = 2
SEQ = 8192
DEPTH = 2

N_MIXERS = 2
D_PLE = 256
D_FF = 2816
GLA_HEADS = 4
GLA_DK = D_MODEL // 2 // GLA_HEADS
GLA_DV = D_MODEL // GLA_HEADS
GLA_KEY = GLA_HEADS * GLA_DK
GLA_VAL = GLA_HEADS * GLA_DV
GLA_GATE_RANK = 16
GLA_TAU = 16.0
GLA_CHUNK = 64
GLA_IN = 2 * GLA_KEY + 2 * GLA_VAL + GLA_GATE_RANK
LRU_WIDTH = (D_MODEL * 3) // 2
LRU_BLOCKS = 6
LRU_BLOCK_DIM = LRU_WIDTH // LRU_BLOCKS
LRU_CONV = 4
LRU_C = 8.0
DN_ALPHA = (2.0 * DEPTH) ** 0.25
DN_BETA = (8.0 * DEPTH) ** -0.25
LN_EPS = 1e-5
N_GLA = (DEPTH + 1) // 2
N_LRU = DEPTH // 2

kernel_name = "hybrid_gla_rglru_macaron_deepnorm"


def layer_norm(x, g, b):
    xf = x.astype(jnp.float32)
    mu = jnp.mean(xf, axis=-1, keepdims=True)
    var = jnp.mean(jnp.square(xf - mu), axis=-1, keepdims=True)
    return ((xf - mu) * lax.rsqrt(var + LN_EPS) * g + b).astype(x.dtype)


def swiglu(x, w_in, w_out):
    g, u = jnp.split(x @ w_in, 2, axis=-1)
    return (jax.nn.silu(g) * u) @ w_out


def gla_mixer(x, w_in, w_gate_up, b_gate, norm_g, w_out):
    B, S, _ = x.shape
    C = GLA_CHUNK
    nC = S // C
    proj = x @ w_in
    q, k, v, r, z = jnp.split(
        proj, [GLA_KEY, 2 * GLA_KEY, 2 * GLA_KEY + GLA_VAL, 2 * GLA_KEY + 2 * GLA_VAL], axis=-1)
    log_g = jax.nn.log_sigmoid((z @ w_gate_up + b_gate).astype(jnp.float32)) / GLA_TAU

    def heads(t, d):
        return t.astype(jnp.float32).reshape(B, nC, C, GLA_HEADS, d).transpose(1, 0, 3, 2, 4)

    qc = heads(q, GLA_DK) * (GLA_DK ** -0.5)
    kc = heads(k, GLA_DK)
    vc = heads(v, GLA_DV)
    gc = heads(log_g, GLA_DK)
    causal = jnp.tril(jnp.ones((C, C), dtype=bool))[:, :, None]

    def step(state, inp):
        q_, k_, v_, g_ = inp
        bcum = jnp.cumsum(g_, axis=2)
        o_inter = jnp.einsum('bhtk,bhkv->bhtv', q_ * jnp.exp(bcum), state)
        diff = bcum[:, :, :, None, :] - bcum[:, :, None, :, :]
        decay = jnp.exp(jnp.where(causal, diff, -jnp.inf))
        scores = jnp.einsum('bhtk,bhsk,bhtsk->bhts', q_, k_, decay)
        o = o_inter + jnp.einsum('bhts,bhsv->bhtv', scores, v_)
        b_last = bcum[:, :, -1:, :]
        new_state = (jnp.exp(b_last[:, :, 0, :])[..., None] * state
                     + jnp.einsum('bhsk,bhsv->bhkv', k_ * jnp.exp(b_last - bcum), v_))
        return new_state, o

    state0 = jnp.zeros((B, GLA_HEADS, GLA_DK, GLA_DV), jnp.float32)
    _, o = lax.scan(step, state0, (qc, kc, vc, gc))
    o = o.transpose(1, 0, 3, 2, 4).reshape(B, S, GLA_HEADS, GLA_DV)
    o = o * lax.rsqrt(jnp.mean(jnp.square(o), axis=-1, keepdims=True) + LN_EPS) * norm_g
    o = o.reshape(B, S, GLA_VAL) * jax.nn.silu(r.astype(jnp.float32))
    return (o.astype(x.dtype) @ w_out).astype(x.dtype)


def _lin_comb(c1, c2):
    a1, b1 = c1
    a2, b2 = c2
    return a1 * a2, a2 * b1 + b2


def rglru_mixer(x, w_in, conv_w, conv_b, w_a, b_a, w_i, b_i, lam, w_out):
    B, S, _ = x.shape
    xb, yb = jnp.split(x @ w_in, 2, axis=-1)
    xpad = jnp.pad(xb, ((0, 0), (LRU_CONV - 1, 0), (0, 0)))
    xc = conv_b + sum(xpad[:, j:j + S, :] * conv_w[j] for j in range(LRU_CONV))
    xh = xc.reshape(B, S, LRU_BLOCKS, LRU_BLOCK_DIM)
    r_gate = jax.nn.sigmoid((jnp.einsum('bsnd,nde->bsne', xh, w_a) + b_a).astype(jnp.float32))
    i_gate = jax.nn.sigmoid((jnp.einsum('bsnd,nde->bsne', xh, w_i) + b_i).astype(jnp.float32))
    r_gate = r_gate.reshape(B, S, LRU_WIDTH)
    i_gate = i_gate.reshape(B, S, LRU_WIDTH)
    log_a = -LRU_C * r_gate * jax.nn.softplus(-lam.astype(jnp.float32))
    a = jnp.exp(log_a)
    mult = jnp.sqrt(jnp.maximum(-jnp.expm1(2.0 * log_a), 0.0))
    bx = mult * (i_gate * xc.astype(jnp.float32))
    _, h = lax.associative_scan(_lin_comb, (a, bx), axis=1)
    y = h * jax.nn.gelu(yb.astype(jnp.float32))
    return (y.astype(x.dtype) @ w_out).astype(x.dtype)


def setup_inputs(seed: int = 0) -> dict:
    key = jax.random.key(seed)
    ks = jax.random.split(key, 24)
    f32 = jnp.float32

    def nrm(k, shape, scale):
        return jax.random.normal(k, shape, f32) * scale

    a0 = jax.random.uniform(ks[19], (N_LRU, LRU_WIDTH), f32, 0.9, 0.999) ** (1.0 / LRU_C)
    lru_lambda = jnp.log(a0) - jnp.log1p(-a0)
    return {
        "x": nrm(ks[0], (BATCH, SEQ, D_MODEL), 1.0),
        "p": nrm(ks[1], (DEPTH, BATCH, SEQ, D_PLE), 1.0),
        "ln_g": 1.0 + nrm(ks[2], (DEPTH, 3, D_MODEL), 0.02),
        "ln_b": nrm(ks[3], (DEPTH, 3, D_MODEL), 0.02),
        "ffn_w_in": nrm(ks[4], (DEPTH, 2, D_MODEL, 2 * D_FF), D_MODEL ** -0.5),
        "ffn_w_out": nrm(ks[5], (DEPTH, 2, D_FF, D_MODEL), DN_BETA * D_FF ** -0.5),
        "gla_w_in": nrm(ks[6], (N_GLA, D_MODEL, GLA_IN), D_MODEL ** -0.5),
        "gla_w_gate_up": nrm(ks[7], (N_GLA, GLA_GATE_RANK, GLA_KEY), GLA_GATE_RANK ** -0.5),
        "gla_b_gate": nrm(ks[8], (N_GLA, GLA_KEY), 0.1),
        "gla_norm_g": 1.0 + nrm(ks[9], (N_GLA, GLA_DV), 0.02),
        "gla_w_out": nrm(ks[10], (N_GLA, GLA_VAL, D_MODEL), DN_BETA * GLA_VAL ** -0.5),
        "lru_w_in": nrm(ks[11], (N_LRU, D_MODEL, 2 * LRU_WIDTH), D_MODEL ** -0.5),
        "lru_conv_w": nrm(ks[12], (N_LRU, LRU_CONV, LRU_WIDTH), LRU_CONV ** -0.5),
        "lru_conv_b": nrm(ks[13], (N_LRU, LRU_WIDTH), 0.02),
        "lru_w_a": nrm(ks[14], (N_LRU, LRU_BLOCKS, LRU_BLOCK_DIM, LRU_BLOCK_DIM), LRU_BLOCK_DIM ** -0.5),
        "lru_b_a": nrm(ks[15], (N_LRU, LRU_BLOCKS, LRU_BLOCK_DIM), 0.02),
        "lru_w_i": nrm(ks[16], (N_LRU, LRU_BLOCKS, LRU_BLOCK_DIM, LRU_BLOCK_DIM), LRU_BLOCK_DIM ** -0.5),
        "lru_b_i": nrm(ks[17], (N_LRU, LRU_BLOCKS, LRU_BLOCK_DIM), 0.02),
        "lru_lambda": lru_lambda,
        "lru_w_out": nrm(ks[18], (N_LRU, LRU_WIDTH, D_MODEL), DN_BETA * LRU_WIDTH ** -0.5),
        "ple_w_gate": nrm(ks[20], (DEPTH, D_MODEL, D_MODEL), D_MODEL ** -0.5),
        "ple_b_gate": nrm(ks[21], (DEPTH, D_MODEL), 0.02),
        "ple_w_proj": nrm(ks[22], (DEPTH, D_PLE, D_MODEL), DN_BETA * D_PLE ** -0.5),
    }


def reference(x, p, ln_g, ln_b, ffn_w_in, ffn_w_out, gla_w_in, gla_w_gate_up, gla_b_gate,
              gla_norm_g, gla_w_out, lru_w_in, lru_conv_w, lru_conv_b, lru_w_a, lru_b_a,
              lru_w_i, lru_b_i, lru_lambda, lru_w_out, ple_w_gate, ple_b_gate, ple_w_proj):
    for i in range(DEPTH):
        x = layer_norm(DN_ALPHA * x + 0.5 * swiglu(x, ffn_w_in[i, 0], ffn_w_out[i, 0]),
                       ln_g[i, 0], ln_b[i, 0])
        j = i // N_MIXERS
        if i % N_MIXERS == 0:
            mix = gla_mixer(x, gla_w_in[j], gla_w_gate_up[j], gla_b_gate[j],
                            gla_norm_g[j], gla_w_out[j])
        else:
            mix = rglru_mixer(x, lru_w_in[j], lru_conv_w[j], lru_conv_b[j], lru_w_a[j],
                              lru_b_a[j], lru_w_i[j], lru_b_i[j], lru_lambda[j], lru_w_out[j])
        x = layer_norm(DN_ALPHA * x + mix, ln_g[i, 1], ln_b[i, 1])
        x = layer_norm(DN_ALPHA * x + 0.5 * swiglu(x, ffn_w_in[i, 1], ffn_w_out[i, 1]),
                       ln_g[i, 2], ln_b[i, 2])
        gate = jax.nn.sigmoid(x @ ple_w_gate[i] + ple_b_gate[i])
        x = x + gate * (p[i] @ ple_w_proj[i])
    return x
```

```cpp
#include <hip/hip_runtime.h>
#include <hip/hip_cooperative_groups.h>
#include <cstdio>
#include <cstdint>
namespace cg = cooperative_groups;
namespace pg8 {
#define PG8_LAS __attribute__((address_space(3)))
typedef unsigned short bf16_t;
typedef short bf16x8 __attribute__((ext_vector_type(8)));
typedef float f32x4 __attribute__((ext_vector_type(4)));
typedef unsigned u32x4 __attribute__((ext_vector_type(4)));
constexpr int BM = 256, BK = 64, HALF = 128, HTB = HALF * BK * 2  , STAGE_BYTES = 8 * HTB, NXCD = 8, WGM = 8;

__host__ __device__ __forceinline__ int lds_byte(int r, int c) { const int st = (r >> 4) * 2 + (c >> 5), rr = r & 15, cc = c & 31, ob = rr * 64 + cc * 2; return st * 1024 + (ob ^ (((ob >> 9) & 1) << 5)); }
__host__ __device__ __forceinline__ void stage_rc(int b, int& R, int& C) { const int st = b / 1024, sb = b % 1024, swz = sb ^ (((sb >> 9) & 1) << 5); R = (st >> 1) * 16 + swz / 64; C = (st & 1) * 32 + (swz % 64) / 2; }
__host__ __device__ __forceinline__ int perm32(int rho) { const int n = rho >> 4, i = rho & 15; return 8 * (i >> 2) + 4 * n + (i & 3); }

struct Unit { int pm, pn; };
struct Gemm { const bf16_t* A; const bf16_t* Bt; int M, N, K, lda; size_t agb; };

struct StaticOrder {
    int nM, nN, nwg, G, c;
    __host__ __device__ void init(int M, int N, int G_, int c_) { nM = M / BM; nN = N / BM; nwg = nM * nN; G = G_; c = c_; }
    __host__ __device__ bool next(int i, Unit& u) const {
        const long L = (long)i * G + c; if (L >= nwg) return false;
        int wgid = (int)L; { const int q = nwg / NXCD, r = nwg % NXCD, xcd = wgid % NXCD, off = wgid / NXCD; wgid = (xcd < r ? xcd * (q + 1) : r * (q + 1) + (xcd - r) * q) + off; }
        const int nig = WGM * nN, gid = wgid / nig, fm = gid * WGM, gsz = (nM - fm) < WGM ? (nM - fm) : WGM;
        u.pm = fm + ((wgid % nig) % gsz); u.pn = (wgid % nig) / gsz; return true;
    }
    __device__ __forceinline__ void a_ready(const Unit&) const {}
    __device__ __forceinline__ void done(const Unit&) const {}
};

typedef __bf16 bf16x2n __attribute__((ext_vector_type(2)));
typedef float f32x2c __attribute__((ext_vector_type(2)));
__device__ __forceinline__ unsigned cvt_pk_bf16(float lo, float hi) { const f32x2c v = {lo, hi}; return __builtin_bit_cast(unsigned, __builtin_convertvector(v, bf16x2n)); }
typedef float f32x2 __attribute__((ext_vector_type(2)));
__device__ __forceinline__ f32x2 gelu_pk(f32x2 v) {
    const f32x2 av = __builtin_elementwise_abs(v), d = av * 0.2316418882f + 1.0f;
    f32x2 t; t.x = __builtin_amdgcn_rcpf(d.x); t.y = __builtin_amdgcn_rcpf(d.y);
    f32x2 q = t * 0.5307027145f + (-0.7265760135f); q = q * t + 0.7107068705f; q = q * t + (-0.142248368f); q = q * t + 0.127414796f; q = q * t;
    const f32x2 s = (v * v) * (-0.72134752044f);
    f32x2 e; e.x = __builtin_amdgcn_exp2f(s.x); e.y = __builtin_amdgcn_exp2f(s.y);
    const f32x2 m = v * (q * e), r = v - m;
    f32x2 o; o.x = v.x < 0.f ? m.x : r.x; o.y = v.y < 0.f ? m.y : r.y; return o;
}

template <int ACT  > struct EpiBf16 {
    static constexpr bool PERM = true, AFTER_DRAIN = false; static_assert(ACT == 0 || ACT == 1, "EpiBf16: ACT is 0 (none) or 1 (gelu_pk)");
    bf16_t* O; int ldc; const float* bias; int split_cols; size_t split_stride; float scale0;
    __device__ __forceinline__ void operator()(const f32x4 (&acc)[2][2][4][2], const Unit& u, int wr, int wc, int fr, int fq) const {
        const int row0 = u.pm * BM + wr * 64 + fr; int colt = u.pn * BM; bf16_t* base = O;
        float sc = 1.f; if (split_cols) { const int t = colt / split_cols; base += (size_t)t * split_stride; colt -= t * split_cols; if (t == 0) sc = scale0; }
        const int col0 = colt + wc * 32 + 8 * fq, bcol0 = u.pn * BM + wc * 32 + 8 * fq;
        f32x4 bv[2][2];
#pragma unroll
        for (int bj = 0; bj < 2; ++bj)
#pragma unroll
            for (int n = 0; n < 2; ++n) bv[bj][n] = bias ? *(const f32x4*)(bias + bcol0 + bj * HALF + 4 * n) : (f32x4){0.f, 0.f, 0.f, 0.f};
#pragma unroll
        for (int ai = 0; ai < 2; ++ai)
#pragma unroll
            for (int m = 0; m < 4; ++m) { bf16_t* rowp = base + (size_t)(row0 + ai * HALF + m * 16) * ldc + col0;
#pragma unroll
                for (int bj = 0; bj < 2; ++bj) { f32x4 v0 = acc[ai][bj][m][0] + bv[bj][0], v1 = acc[ai][bj][m][1] + bv[bj][1];
                    if (ACT == 1) { f32x2 a = gelu_pk((f32x2){v0[0], v0[1]}), b = gelu_pk((f32x2){v0[2], v0[3]}), c = gelu_pk((f32x2){v1[0], v1[1]}), d = gelu_pk((f32x2){v1[2], v1[3]});
                        v0 = (f32x4){a.x, a.y, b.x, b.y}; v1 = (f32x4){c.x, c.y, d.x, d.y}; }
                    v0 = v0 * sc; v1 = v1 * sc; u32x4 w; w.x = cvt_pk_bf16(v0[0], v0[1]); w.y = cvt_pk_bf16(v0[2], v0[3]); w.z = cvt_pk_bf16(v1[0], v1[1]); w.w = cvt_pk_bf16(v1[2], v1[3]);
                    *(u32x4*)(rowp + bj * HALF) = w; } }
    }
};


template <class Epi, class Sched, bool ALIGN_EPI = false, bool SP2 = false>
__device__ __forceinline__ void gemm_phase(PG8_LAS unsigned char* lds, const Gemm g, const Sched& S, const Epi& E) {
    int tid_ = threadIdx.x; asm volatile("" : "+v"(tid_));
    const int tid = tid_, wid = __builtin_amdgcn_readfirstlane(tid >> 6), lane = tid & 63, wr = wid >> 2, wc = wid & 3, fr = lane & 15, fq = lane >> 4;
    const int K = g.K, nt = K / BK;
    unsigned voffA[2], voffB[2];
#pragma unroll
    for (int i = 0; i < 2; ++i) { int R, C; stage_rc(tid * 16 + i * 8192, R, C); const int Rb = Epi::PERM ? ((R & ~31) + perm32(R & 31)) : R;
        voffA[i] = (unsigned)(R * g.lda + C) * 2u; voffB[i] = (unsigned)(Rb * K + C) * 2u; }
    const size_t kstep = (size_t)(BK * 2);
    const size_t hstep = (size_t)HALF * K * 2;
    const size_t tstep = 2 * hstep; const size_t hstepA = (size_t)HALF * g.lda * 2, tstepA = 2 * hstepA;
    const unsigned ldsw = (unsigned)wid * 1024u;
    const int aoff = lds_byte(wr * 64 + fr, fq * 8), boff = lds_byte(wc * 32 + fr, fq * 8);
#define PG8_SA(b, h) (((b) * 2 + (h)) * HTB)
#define PG8_SB(b, h) ((4 + (b) * 2 + (h)) * HTB)
#define PG8_STAGE(bufoff, gbase, voff) do { _Pragma("unroll") for (int _i = 0; _i < 2; ++_i) \
        __builtin_amdgcn_global_load_lds((const unsigned*)((const char*)(gbase) + (voff)[_i]), (PG8_LAS unsigned*)(lds + (bufoff) + ldsw + _i * 8192), 16, 0, 0); } while (0)
#define PG8_LDA(dst, b, h) do { _Pragma("unroll") for (int m = 0; m < 4; ++m) _Pragma("unroll") for (int k = 0; k < 2; ++k) dst[m][k] = *(const PG8_LAS bf16x8*)(lds + PG8_SA(b, h) + aoff + m * 2048 + k * 1024); } while (0)
#define PG8_LDB(dst, b, h) do { _Pragma("unroll") for (int n = 0; n < 2; ++n) _Pragma("unroll") for (int k = 0; k < 2; ++k) dst[n][k] = *(const PG8_LAS bf16x8*)(lds + PG8_SB(b, h) + boff + n * 2048 + k * 1024); } while (0)
#define PG8_MMA(ai, bj, At, Bt) do { __builtin_amdgcn_s_setprio(1); _Pragma("unroll") for (int m = 0; m < 4; ++m) _Pragma("unroll") for (int n = 0; n < 2; ++n) _Pragma("unroll") for (int k = 0; k < 2; ++k) \
        acc[ai][bj][m][n] = __builtin_amdgcn_mfma_f32_16x16x32_bf16(Bt[n][k], At[m][k], acc[ai][bj][m][n], 0, 0, 0); __builtin_amdgcn_s_setprio(0); } while (0)
#define PG8_WAIT_V(n) asm volatile("s_waitcnt vmcnt(" #n ")" ::: "memory")
#define PG8_WAIT_L(n) asm volatile("s_waitcnt lgkmcnt(" #n ")" ::: "memory")
#define PG8_BAR __builtin_amdgcn_s_barrier()
#define PG8_SCHED __builtin_amdgcn_sched_barrier(0)
    Unit cur, nxt; int ui = 0;
    if (!S.next(0, cur)) return;
    f32x4 acc[2][2][4][2];
#pragma unroll
    for (int a = 0; a < 2; ++a)
#pragma unroll
        for (int b = 0; b < 2; ++b)
#pragma unroll
            for (int m = 0; m < 4; ++m)
#pragma unroll
                for (int n = 0; n < 2; ++n) acc[a][b][m][n] = (f32x4){0.f, 0.f, 0.f, 0.f};
    bf16x8 At[4][2], B0[2][2], B1[2][2];
    const char* cA = (const char*)g.A + (size_t)cur.pm * tstepA + (size_t)(cur.pn >> 1) * g.agb; const char* cB = (const char*)g.Bt + (size_t)cur.pn * tstep;
    S.a_ready(cur);
    if constexpr (SP2) {
        PG8_STAGE(PG8_SB(0, 0), cB, voffB); PG8_STAGE(PG8_SB(0, 1), cB + hstep, voffB); PG8_STAGE(PG8_SA(0, 0), cA, voffA); PG8_STAGE(PG8_SA(0, 1), cA + hstepA, voffA);
        if (wr == 1) PG8_BAR;
        PG8_WAIT_V(2); PG8_BAR;
        PG8_STAGE(PG8_SB(1, 0), cB + kstep, voffB); PG8_STAGE(PG8_SA(1, 0), cA + kstep, voffA); PG8_STAGE(PG8_SB(1, 1), cB + hstep + kstep, voffB);
        PG8_WAIT_V(6); PG8_BAR;
    } else {
        PG8_STAGE(PG8_SB(0, 0), cB, voffB); PG8_STAGE(PG8_SA(0, 0), cA, voffA); PG8_STAGE(PG8_SB(0, 1), cB + hstep, voffB); PG8_STAGE(PG8_SA(0, 1), cA + hstepA, voffA);
        if (wr == 1) PG8_BAR;
        PG8_WAIT_V(4); PG8_BAR;
        PG8_STAGE(PG8_SB(1, 0), cB + kstep, voffB); PG8_STAGE(PG8_SA(1, 0), cA + kstep, voffA); PG8_STAGE(PG8_SB(1, 1), cB + hstep + kstep, voffB);
        PG8_WAIT_V(6); PG8_BAR;
    }
    for (;;) {
        const bool has_next = S.next(ui + 1, nxt);
        const char* nA = has_next ? (const char*)g.A + (size_t)nxt.pm * tstepA + (size_t)(nxt.pn >> 1) * g.agb : cA; const char* nB = has_next ? (const char*)g.Bt + (size_t)nxt.pn * tstep : cB;
        for (int t = 0; t < nt; t += 2) {
            const bool last = (t == nt - 2);
            const char* a1 = cA + (size_t)(t + 1) * kstep;
            const char* a2 = last ? nA : cA + (size_t)(t + 2) * kstep; const char* b2 = last ? nB : cB + (size_t)(t + 2) * kstep;
            const char* a3 = a2 + kstep; const char* b3 = b2 + kstep;
            if (last && has_next) S.a_ready(nxt);
            if constexpr (SP2) {
            PG8_LDB(B0, 0, 0); PG8_LDB(B1, 0, 1); PG8_SCHED; PG8_LDA(At, 0, 0); PG8_STAGE(PG8_SA(1, 1), a1 + hstepA, voffA);
            PG8_WAIT_V(8); PG8_WAIT_L(0); PG8_BAR; PG8_MMA(0, 0, At, B0); PG8_MMA(0, 1, At, B1); PG8_BAR; PG8_SCHED;
            PG8_LDA(At, 0, 1); PG8_STAGE(PG8_SB(0, 0), b2, voffB); PG8_STAGE(PG8_SB(0, 1), b2 + hstep, voffB); PG8_STAGE(PG8_SA(0, 0), a2, voffA);
            PG8_WAIT_V(8); PG8_WAIT_L(0); PG8_BAR; PG8_MMA(1, 0, At, B0); PG8_MMA(1, 1, At, B1); PG8_BAR; PG8_SCHED;
            PG8_LDB(B0, 1, 0); PG8_LDB(B1, 1, 1); PG8_SCHED; PG8_LDA(At, 1, 0); PG8_STAGE(PG8_SA(0, 1), a2 + hstepA, voffA);
            PG8_WAIT_V(8); PG8_WAIT_L(0); PG8_BAR; PG8_MMA(0, 0, At, B0); PG8_MMA(0, 1, At, B1); PG8_BAR; PG8_SCHED;
            PG8_LDA(At, 1, 1); PG8_STAGE(PG8_SB(1, 0), b3, voffB); PG8_STAGE(PG8_SB(1, 1), b3 + hstep, voffB); PG8_STAGE(PG8_SA(1, 0), a3, voffA);
            PG8_WAIT_V(8); PG8_WAIT_L(0); PG8_BAR; PG8_MMA(1, 0, At, B0); PG8_MMA(1, 1, At, B1); PG8_BAR; PG8_SCHED;
            } else {
            PG8_LDB(B0, 0, 0); PG8_SCHED; PG8_LDA(At, 0, 0); PG8_STAGE(PG8_SA(1, 1), a1 + hstepA, voffA);
            PG8_WAIT_L(8); PG8_BAR; PG8_WAIT_L(0); PG8_MMA(0, 0, At, B0); PG8_BAR; PG8_SCHED;
            PG8_LDB(B1, 0, 1); PG8_STAGE(PG8_SB(0, 0), b2, voffB);
            PG8_BAR; PG8_WAIT_L(0); PG8_MMA(0, 1, At, B1); PG8_BAR;
            PG8_LDA(At, 0, 1); PG8_STAGE(PG8_SA(0, 0), a2, voffA);
            PG8_BAR; PG8_WAIT_L(0); PG8_MMA(1, 0, At, B0); PG8_BAR; PG8_SCHED;
            PG8_STAGE(PG8_SB(0, 1), b2 + hstep, voffB);
            PG8_WAIT_V(6); PG8_BAR; PG8_MMA(1, 1, At, B1); PG8_BAR;
            PG8_LDB(B0, 1, 0); PG8_SCHED; PG8_LDA(At, 1, 0); PG8_STAGE(PG8_SA(0, 1), a2 + hstepA, voffA);
            PG8_WAIT_L(8); PG8_BAR; PG8_WAIT_L(0); PG8_MMA(0, 0, At, B0); PG8_BAR; PG8_SCHED;
            PG8_LDB(B1, 1, 1); PG8_STAGE(PG8_SB(1, 0), b3, voffB);
            PG8_BAR; PG8_WAIT_L(0); PG8_MMA(0, 1, At, B1); PG8_BAR;
            PG8_LDA(At, 1, 1); PG8_STAGE(PG8_SA(1, 0), a3, voffA);
            PG8_BAR; PG8_WAIT_L(0); PG8_MMA(1, 0, At, B0); PG8_BAR; PG8_SCHED;
            PG8_STAGE(PG8_SB(1, 1), b3 + hstep, voffB);
            PG8_WAIT_V(6); PG8_BAR; PG8_MMA(1, 1, At, B1); PG8_BAR;
            }
        }
        if constexpr (ALIGN_EPI) { if (wr == 0) PG8_BAR; }
        if constexpr (!Epi::AFTER_DRAIN) { E(acc, cur, wr, wc, fr, fq); S.done(cur); }
        if (!has_next) break;
#pragma unroll
        for (int a = 0; a < 2; ++a)
#pragma unroll
            for (int b = 0; b < 2; ++b)
#pragma unroll
                for (int m = 0; m < 4; ++m)
#pragma unroll
                    for (int n = 0; n < 2; ++n) acc[a][b][m][n] = (f32x4){0.f, 0.f, 0.f, 0.f};
        cur = nxt; cA = nA; cB = nB; ++ui;
        if constexpr (ALIGN_EPI) { if (wr == 1) PG8_BAR; }
    }
    PG8_WAIT_V(0);
    if constexpr (!ALIGN_EPI) { if (wr == 0) PG8_BAR; }
    PG8_BAR;
    if constexpr (Epi::AFTER_DRAIN) { E.fused(acc, cur, wr, wc, fr, fq, lds, wid, lane); S.done(cur); }
#undef PG8_SA
#undef PG8_SB
#undef PG8_STAGE
#undef PG8_LDA
#undef PG8_LDB
#undef PG8_MMA
#undef PG8_WAIT_V
#undef PG8_WAIT_L
#undef PG8_BAR
#undef PG8_SCHED
}
}
namespace pg8 {
__device__ __forceinline__ float sigm(float x) { return __builtin_amdgcn_rcpf(1.0f + __expf(-x)); }
__device__ __forceinline__ float bf_lo(unsigned w) { return __uint_as_float(w << 16); }
__device__ __forceinline__ float bf_hi(unsigned w) { return __uint_as_float(w & 0xffff0000u); }
typedef unsigned u32x2 __attribute__((ext_vector_type(2)));

struct EpiSwiGLU {
    static constexpr bool PERM = true, AFTER_DRAIN = false;
    bf16_t* O; int ldc;
    __device__ __forceinline__ void operator()(const f32x4 (&acc)[2][2][4][2], const Unit& u, int wr, int wc, int fr, int fq) const {
        const int row0 = u.pm * BM + wr * 64 + fr, col0 = u.pn * HALF + wc * 32 + 8 * fq;
#pragma unroll
        for (int ai = 0; ai < 2; ++ai)
#pragma unroll
            for (int m = 0; m < 4; ++m) {
                bf16_t* rowp = O + (size_t)(row0 + ai * HALF + m * 16) * ldc + col0;
                float o[8];
#pragma unroll
                for (int n = 0; n < 2; ++n)
#pragma unroll
                    for (int j = 0; j < 4; ++j) { const float g = acc[ai][0][m][n][j], uu = acc[ai][1][m][n][j]; o[4 * n + j] = g * sigm(g) * uu; }
                u32x4 w; w.x = cvt_pk_bf16(o[0], o[1]); w.y = cvt_pk_bf16(o[2], o[3]); w.z = cvt_pk_bf16(o[4], o[5]); w.w = cvt_pk_bf16(o[6], o[7]);
                *(u32x4*)rowp = w;
            }
    }
};
struct EpiResid {
    static constexpr bool PERM = false, AFTER_DRAIN = false;
    const float* base; float* out; int ldc; float alpha, s;
    __device__ __forceinline__ void operator()(const f32x4 (&acc)[2][2][4][2], const Unit& u, int wr, int wc, int fr, int fq) const {
        const int row0 = u.pm * BM + wr * 64 + fr, col0 = u.pn * BM + wc * 32 + 4 * fq;
#pragma unroll
        for (int ai = 0; ai < 2; ++ai)
#pragma unroll
            for (int m = 0; m < 4; ++m) { const size_t off = (size_t)(row0 + ai * HALF + m * 16) * ldc + col0;
#pragma unroll
                for (int bj = 0; bj < 2; ++bj)
#pragma unroll
                    for (int n = 0; n < 2; ++n) { const size_t p = off + bj * HALF + n * 16; const f32x4 b = *(const f32x4*)(base + p); *(f32x4*)(out + p) = b * alpha + acc[ai][bj][m][n] * s; }
                asm volatile("" ::: "memory"); }
    }
};
struct EpiF32 {
    static constexpr bool PERM = false, AFTER_DRAIN = false;
    float* C; int ldc;
    __device__ __forceinline__ void operator()(const f32x4 (&acc)[2][2][4][2], const Unit& u, int wr, int wc, int fr, int fq) const {
        const int row0 = u.pm * BM + wr * 64 + fr, col0 = u.pn * BM + wc * 32 + 4 * fq;
#pragma unroll
        for (int ai = 0; ai < 2; ++ai)
#pragma unroll
            for (int m = 0; m < 4; ++m) { float* rowp = C + (size_t)(row0 + ai * HALF + m * 16) * ldc + col0;
#pragma unroll
                for (int bj = 0; bj < 2; ++bj)
#pragma unroll
                    for (int n = 0; n < 2; ++n) *(f32x4*)(rowp + bj * HALF + n * 16) = acc[ai][bj][m][n]; }
    }
};
struct EpiPle {
    static constexpr bool PERM = false, AFTER_DRAIN = false;
    float* X; const float* PP; const float* bg; bf16_t* XBn; int ldc;
    __device__ __forceinline__ void operator()(const f32x4 (&acc)[2][2][4][2], const Unit& u, int wr, int wc, int fr, int fq) const {
        const int row0 = u.pm * BM + wr * 64 + fr, col0 = u.pn * BM + wc * 32 + 4 * fq;
        f32x4 bv[2][2];
#pragma unroll
        for (int bj = 0; bj < 2; ++bj)
#pragma unroll
            for (int n = 0; n < 2; ++n) bv[bj][n] = *(const f32x4*)(bg + col0 + bj * HALF + n * 16);
#pragma unroll
        for (int ai = 0; ai < 2; ++ai)
#pragma unroll
            for (int m = 0; m < 4; ++m) { const size_t off = (size_t)(row0 + ai * HALF + m * 16) * ldc + col0;
#pragma unroll
                for (int bj = 0; bj < 2; ++bj)
#pragma unroll
                    for (int n = 0; n < 2; ++n) { const size_t p = off + bj * HALF + n * 16; const f32x4 x = *(const f32x4*)(X + p), pp = *(const f32x4*)(PP + p), v = acc[ai][bj][m][n] + bv[bj][n];
                        f32x4 o; o[0] = x[0] + sigm(v[0]) * pp[0]; o[1] = x[1] + sigm(v[1]) * pp[1]; o[2] = x[2] + sigm(v[2]) * pp[2]; o[3] = x[3] + sigm(v[3]) * pp[3];
                        *(f32x4*)(X + p) = o;
                        if (XBn) { u32x2 w; w.x = cvt_pk_bf16(o[0], o[1]); w.y = cvt_pk_bf16(o[2], o[3]); *(u32x2*)(XBn + p) = w; } }
                asm volatile("" ::: "memory"); }
    }
};
struct EpiLruGate {
    static constexpr bool PERM = true, AFTER_DRAIN = false;
    const bf16_t* XC; bf16_t* LA; bf16_t* BX; const float* ba; const float* bi; const float* lam; int ld;
    __device__ __forceinline__ void operator()(const f32x4 (&acc)[2][2][4][2], const Unit& u, int wr, int wc, int fr, int fq) const {
        const int row0 = u.pm * BM + wr * 64 + fr, ch0 = u.pn * HALF + wc * 32 + 8 * fq;
        float sp[8], bav[8], biv[8];
#pragma unroll
        for (int q = 0; q < 8; ++q) { const float x = -lam[ch0 + q]; const float ee = __expf(-fabsf(x)); sp[q] = fmaxf(x, 0.f) + (ee < 0.01f ? ee * (1.0f - ee * (0.5f - ee * (1.0f / 3.0f))) : __logf(1.0f + ee)); bav[q] = ba[ch0 + q]; biv[q] = bi[ch0 + q]; }
#pragma unroll
        for (int ai = 0; ai < 2; ++ai)
#pragma unroll
            for (int m = 0; m < 4; ++m) { const size_t off = (size_t)(row0 + ai * HALF + m * 16) * ld + ch0;
                const u32x4 xw = *(const u32x4*)(XC + off);
                const float xc[8] = {bf_lo(xw.x), bf_hi(xw.x), bf_lo(xw.y), bf_hi(xw.y), bf_lo(xw.z), bf_hi(xw.z), bf_lo(xw.w), bf_hi(xw.w)};
                float la[8], bx[8];
#pragma unroll
                for (int q = 0; q < 8; ++q) { const float r = sigm(acc[ai][0][m][q >> 2][q & 3] + bav[q]), ig = sigm(acc[ai][1][m][q >> 2][q & 3] + biv[q]);
                    la[q] = -8.0f * r * sp[q]; const float t2 = 2.0f * la[q];
                    const float em = t2 > -0.1f ? t2 * (1.0f + t2 * (0.5f + t2 * ((1.0f / 6.0f) + t2 * ((1.0f / 24.0f) + t2 * (1.0f / 120.0f))))) : __expf(t2) - 1.0f;
                    const float mult = sqrtf(fmaxf(-em, 0.f)); bx[q] = mult * ig * xc[q]; }
                u32x4 w; w.x = cvt_pk_bf16(la[0], la[1]); w.y = cvt_pk_bf16(la[2], la[3]); w.z = cvt_pk_bf16(la[4], la[5]); w.w = cvt_pk_bf16(la[6], la[7]);
                *(u32x4*)(LA + off) = w;
                w.x = cvt_pk_bf16(bx[0], bx[1]); w.y = cvt_pk_bf16(bx[2], bx[3]); w.z = cvt_pk_bf16(bx[4], bx[5]); w.w = cvt_pk_bf16(bx[6], bx[7]);
                *(u32x4*)(BX + off) = w;
                asm volatile("" ::: "memory"); }
    }
};
}
#define LAS __attribute__((address_space(3)))
typedef unsigned short bf16;
typedef unsigned v4u __attribute__((ext_vector_type(4)));
typedef unsigned v2u __attribute__((ext_vector_type(2)));
typedef float f32x4 __attribute__((ext_vector_type(4)));
typedef float f32x2v __attribute__((ext_vector_type(2)));
typedef short bf16x8 __attribute__((ext_vector_type(8)));
#define LDS_WAIT() asm volatile("s_waitcnt lgkmcnt(0)" ::: "memory")
using pg8::cvt_pk_bf16; using pg8::bf_lo; using pg8::bf_hi; using pg8::sigm;

#ifndef MK_N_LAUNCHES
#define MK_N_LAUNCHES 28
#endif
constexpr int NWAVES = 8, NTHR = 512;
constexpr int BATCH = 2, SEQ = 8192, D = 1024, M = BATCH * SEQ, FF = 2816, DPLE = 256;
constexpr int GIN = 3088;
constexpr int LW = 1536;
constexpr float LN_EPS = 1e-5f, DN_ALPHA = 1.41421356237f;
constexpr int N_PHASES = 28;

constexpr size_t MiB = 1u << 20;
constexpr size_t WS_WIN = 2 * MiB;
constexpr size_t WS_WOUT = 46 * MiB;
constexpr size_t WS_WG1 = 68 * MiB;
constexpr size_t WS_WV = 72 * MiB;
constexpr size_t WS_WZ = 74 * MiB;
constexpr size_t WS_GWO = 75 * MiB;
constexpr size_t WS_LIN = 77 * MiB;
constexpr size_t WS_WGT = 83 * MiB;
constexpr size_t WS_LWO = 85 * MiB;
constexpr size_t WS_PG = 88 * MiB;
constexpr size_t WS_PPJ = 92 * MiB;
constexpr size_t WS_PB = 94 * MiB;
constexpr size_t WS_XB = 110 * MiB;
constexpr size_t WS_S = 142 * MiB;
constexpr size_t WS_END = 342 * MiB;
constexpr size_t S_ACT = WS_S;
constexpr size_t S_QKR = WS_S, S_VT = WS_S + 64 * MiB, S_BCUM = WS_S + 96 * MiB, S_SL = WS_S + 128 * MiB;
constexpr size_t S_XBR = WS_S, S_YBR = WS_S + 48 * MiB, S_XC = WS_S + 96 * MiB, S_LA = WS_S + 144 * MiB, S_CAR = WS_S + 192 * MiB;
constexpr size_t S_PP = WS_S, S_XB2 = WS_S + 128 * MiB;

constexpr int LDS_BYTES = 147456;

__device__ __forceinline__ float wave_sum(float v) {
#pragma unroll
    for (int o = 1; o < 64; o <<= 1) v += __shfl_xor(v, o);
    return v;
}
__device__ __forceinline__ float softplusf(float x) { return fmaxf(x, 0.f) + log1pf(__expf(-fabsf(x))); }

__device__ __forceinline__ void tr_item(const float* W, int ldw, int K, bf16* WT, int k0, int ncol0, int drow0, LAS float* scr, int lane) {
#pragma unroll 8
    for (int i = 0; i < 32; ++i) { const int kk = 2 * i + (lane >> 5); scr[kk * 33 + (lane & 31)] = W[(size_t)(k0 + kk) * ldw + ncol0 + (lane & 31)]; }
    LDS_WAIT(); asm volatile("" ::: "memory");
    const int c = lane & 7;
#pragma unroll
    for (int j = 0; j < 4; ++j) { const int n = (lane >> 3) + 8 * j; const LAS float* s = scr + (8 * c) * 33 + n;
        v4u o; o.x = cvt_pk_bf16(s[0 * 33], s[1 * 33]); o.y = cvt_pk_bf16(s[2 * 33], s[3 * 33]); o.z = cvt_pk_bf16(s[4 * 33], s[5 * 33]); o.w = cvt_pk_bf16(s[6 * 33], s[7 * 33]);
        *(v4u*)(WT + (size_t)(drow0 + n) * K + k0 + 8 * c) = o; }
    LDS_WAIT(); asm volatile("" ::: "memory");
}
template <int KIND> __device__ __forceinline__ void prep_mat(const float* W, int ldw, int K, int ncols, int col0, bf16* WT, int row_off, LAS float* scr, int gw, int NGW, int lane) {
    const int nblk = ncols / 32, nitems = (K / 64) * nblk;
    for (int it = gw; it < nitems; it += NGW) { const int kb = it / nblk, nb = it % nblk, n0 = 32 * nb;
        const int drow = KIND == 0 ? row_off + n0 : row_off + (n0 >> 7) * 256 + (n0 & 127);
        tr_item(W, ldw, K, WT, 64 * kb, col0 + n0, drow, scr, lane); }
}
__device__ __forceinline__ void cvt_rows(const float* src, bf16* dst, size_t n4, size_t gtid, size_t GT) {
    for (size_t i = gtid; i < n4; i += GT) { const f32x4 v = ((const f32x4*)src)[i]; v2u w; w.x = cvt_pk_bf16(v[0], v[1]); w.y = cvt_pk_bf16(v[2], v[3]); ((v2u*)dst)[i] = w; }
}

__device__ __forceinline__ void ln_phase(float* X, bf16* XB, const float* g, const float* b, int gw, int NGW, int lane) {
    f32x4 gv[4], bv[4];
#pragma unroll
    for (int j = 0; j < 4; ++j) { gv[j] = ((const f32x4*)g)[lane + 64 * j]; bv[j] = ((const f32x4*)b)[lane + 64 * j]; }
    for (int m = gw; m < M; m += NGW) {
        f32x4* xr = (f32x4*)(X + (size_t)m * D) + lane;
        f32x4 v[4]; float s = 0.f;
#pragma unroll
        for (int j = 0; j < 4; ++j) { v[j] = xr[64 * j]; s += (v[j][0] + v[j][1]) + (v[j][2] + v[j][3]); }
        const float mean = wave_sum(s) * (1.f / D); float s2 = 0.f;
#pragma unroll
        for (int j = 0; j < 4; ++j) { v[j] = v[j] - mean; s2 += (v[j][0] * v[j][0] + v[j][1] * v[j][1]) + (v[j][2] * v[j][2] + v[j][3] * v[j][3]); }
        const float rstd = 1.f / sqrtf(wave_sum(s2) * (1.f / D) + LN_EPS);
        v2u* o8 = (v2u*)(XB + (size_t)m * D) + lane;
#pragma unroll
        for (int j = 0; j < 4; ++j) { const f32x4 o = v[j] * rstd * gv[j] + bv[j]; xr[64 * j] = o; v2u w; w.x = cvt_pk_bf16(o[0], o[1]); w.y = cvt_pk_bf16(o[2], o[3]); o8[64 * j] = w; }
    }
}

__device__ __forceinline__ void gla_gate_phase(const bf16* XB, const bf16* WZ, const float* wgu, const float* bgate, float* BCUM, LAS unsigned char* lds, int tid, int wave, int lane, int G) {
    LAS float* zs = (LAS float*)lds;
    for (int task = blockIdx.x; task < M / 64; task += G) {
        const int row0 = task * 64;
        { const int rt = wave & 3, kh = wave >> 2; f32x4 acc = {0.f, 0.f, 0.f, 0.f};
          const bf16* ap = XB + (size_t)(row0 + rt * 16 + (lane & 15)) * D + kh * 512 + 8 * (lane >> 4);
          const bf16* bp = WZ + (size_t)(lane & 15) * D + kh * 512 + 8 * (lane >> 4);
#pragma unroll 4
          for (int ks = 0; ks < 16; ++ks) { const bf16x8 a = *(const bf16x8*)(ap + ks * 32), b = *(const bf16x8*)(bp + ks * 32); acc = __builtin_amdgcn_mfma_f32_16x16x32_bf16(a, b, acc, 0, 0, 0); }
#pragma unroll
          for (int r = 0; r < 4; ++r) zs[kh * 1024 + (rt * 16 + 4 * (lane >> 4) + r) * 16 + (lane & 15)] = acc[r]; }
        __syncthreads();
        { const int c = tid; float wc[16];
#pragma unroll
          for (int j = 0; j < 16; ++j) wc[j] = wgu[j * 512 + c];
          const float bc = bgate[c]; float cum = 0.f;
          for (int row = 0; row < 64; ++row) {
              float pre = bc;
#pragma unroll
              for (int q = 0; q < 4; ++q) { const f32x4 z0 = *(const LAS f32x4*)(zs + row * 16 + 4 * q), z1 = *(const LAS f32x4*)(zs + 1024 + row * 16 + 4 * q);
#pragma unroll
                  for (int j = 0; j < 4; ++j) pre += (z0[j] + z1[j]) * wc[4 * q + j]; }
              cum += -softplusf(-pre) * (1.0f / 16.0f);
              BCUM[(size_t)(row0 + row) * 512 + c] = cum; } }
        __syncthreads();
    }
}

__device__ __forceinline__ void gla_local_phase(const bf16* QKR, const bf16* VT, const float* BCUM, bf16* SL, LAS unsigned char* lds, int tid, int wave, int lane, int G) {
    LAS bf16* KT = (LAS bf16*)lds;
    const int fr = lane & 15, fq = lane >> 4;
    for (int u = blockIdx.x; u < 1024; u += G) {
        const int h = u & 3, row0 = (u >> 2) * 64;
        for (int idx = tid; idx < 1024; idx += NTHR) { const int s2 = idx >> 5, g4 = idx & 31;
            const size_t r0 = (size_t)(row0 + 2 * s2);
            const v2u ka = *(const v2u*)(QKR + r0 * 2048 + 512 + h * 128 + g4 * 4), kb = *(const v2u*)(QKR + (r0 + 1) * 2048 + 512 + h * 128 + g4 * 4);
            const f32x4 ca = *(const f32x4*)(BCUM + r0 * 512 + h * 128 + g4 * 4), cb = *(const f32x4*)(BCUM + (r0 + 1) * 512 + h * 128 + g4 * 4);
            const f32x4 bl = *(const f32x4*)(BCUM + (size_t)(row0 + 63) * 512 + h * 128 + g4 * 4);
            const float fa[4] = {bf_lo(ka.x), bf_hi(ka.x), bf_lo(ka.y), bf_hi(ka.y)}, fb[4] = {bf_lo(kb.x), bf_hi(kb.x), bf_lo(kb.y), bf_hi(kb.y)};
#pragma unroll
            for (int i = 0; i < 4; ++i) *(LAS unsigned*)(KT + (g4 * 4 + i) * 72 + 2 * s2) = cvt_pk_bf16(fa[i] * __expf(bl[i] - ca[i]), fb[i] * __expf(bl[i] - cb[i])); }
        __syncthreads();
        f32x4 acc[8][2];
#pragma unroll
        for (int mt = 0; mt < 8; ++mt) { acc[mt][0] = (f32x4){0.f, 0.f, 0.f, 0.f}; acc[mt][1] = (f32x4){0.f, 0.f, 0.f, 0.f}; }
#pragma unroll
        for (int ks = 0; ks < 2; ++ks) { bf16x8 bv[2];
#pragma unroll
            for (int nt = 0; nt < 2; ++nt) bv[nt] = *(const bf16x8*)(VT + (size_t)(h * 256 + 32 * wave + 16 * nt + fr) * M + row0 + 32 * ks + 8 * fq);
#pragma unroll
            for (int mt = 0; mt < 8; ++mt) { const bf16x8 a = *(const LAS bf16x8*)(KT + (16 * mt + fr) * 72 + 32 * ks + 8 * fq);
                acc[mt][0] = __builtin_amdgcn_mfma_f32_16x16x32_bf16(a, bv[0], acc[mt][0], 0, 0, 0); acc[mt][1] = __builtin_amdgcn_mfma_f32_16x16x32_bf16(a, bv[1], acc[mt][1], 0, 0, 0); } }
#pragma unroll
        for (int mt = 0; mt < 8; ++mt)
#pragma unroll
            for (int nt = 0; nt < 2; ++nt) { v2u w; w.x = cvt_pk_bf16(acc[mt][nt][0], acc[mt][nt][1]); w.y = cvt_pk_bf16(acc[mt][nt][2], acc[mt][nt][3]);
                *(v2u*)(SL + (size_t)u * 32768 + (size_t)(32 * wave + 16 * nt + fr) * 128 + 16 * mt + 4 * fq) = w; }
        __syncthreads();
    }
}

__device__ __forceinline__ void gla_scan_phase(bf16* SL, const float* BCUM, int gtid, int GT) {
    for (int p = gtid; p < 131072; p += GT) {
        const int bh = p >> 14, e2 = p & 16383, b = bh >> 2, h = bh & 3, kd = (2 * e2) & 127;
        unsigned* ptr = (unsigned*)SL + ((size_t)(b * 128) * 4 + h) * 16384 + e2;
        const float* blp = BCUM + (size_t)(b * SEQ + 63) * 512 + h * 128 + kd;
        float s0 = 0.f, s1 = 0.f;
        for (int c0 = 0; c0 < 128; c0 += 8) {
            unsigned sl[8]; f32x2v bl[8];
#pragma unroll
            for (int i = 0; i < 8; ++i) { sl[i] = ptr[(size_t)(c0 + i) * 65536]; bl[i] = *(const f32x2v*)(blp + (size_t)(c0 + i) * 32768); }
#pragma unroll
            for (int i = 0; i < 8; ++i) { ptr[(size_t)(c0 + i) * 65536] = cvt_pk_bf16(s0, s1); s0 = __expf(bl[i][0]) * s0 + bf_lo(sl[i]); s1 = __expf(bl[i][1]) * s1 + bf_hi(sl[i]); }
        }
    }
}

__device__ __forceinline__ void gla_out_phase(bf16* QKR, const bf16* VT, const float* BCUM, const bf16* SST, const float* norm_g, LAS unsigned char* lds, int tid, int wave, int lane, int G) {
    LAS bf16* Ps = (LAS bf16*)lds;
    LAS float* red = (LAS float*)(lds + 9216);
    const int fr = lane & 15, fq = lane >> 4;
    for (int u = blockIdx.x; u < 1024; u += G) {
        const int h = u & 3, row0 = (u >> 2) * 64;
        bf16x8 qf[4][4];
#pragma unroll
        for (int tt = 0; tt < 4; ++tt)
#pragma unroll
            for (int ks = 0; ks < 4; ++ks) { const int t = 16 * tt + fr, kd = 32 * ks + 8 * fq;
                const v4u qw = *(const v4u*)(QKR + (size_t)(row0 + t) * 2048 + h * 128 + kd);
                const float* bcp = BCUM + (size_t)(row0 + t) * 512 + h * 128 + kd; const f32x4 c0 = *(const f32x4*)bcp, c1 = *(const f32x4*)(bcp + 4);
                const float sc = 0.08838834764831845f;
                v4u o; o.x = cvt_pk_bf16(bf_lo(qw.x) * sc * __expf(c0[0]), bf_hi(qw.x) * sc * __expf(c0[1])); o.y = cvt_pk_bf16(bf_lo(qw.y) * sc * __expf(c0[2]), bf_hi(qw.y) * sc * __expf(c0[3]));
                o.z = cvt_pk_bf16(bf_lo(qw.z) * sc * __expf(c1[0]), bf_hi(qw.z) * sc * __expf(c1[1])); o.w = cvt_pk_bf16(bf_lo(qw.w) * sc * __expf(c1[2]), bf_hi(qw.w) * sc * __expf(c1[3]));
                qf[tt][ks] = __builtin_bit_cast(bf16x8, o); }
        { const int tt = wave >> 1;
#pragma unroll
          for (int sti = 0; sti < 2; ++sti) { const int st = 2 * (wave & 1) + sti; f32x4 pacc = {0.f, 0.f, 0.f, 0.f};
#pragma unroll
              for (int ks = 0; ks < 4; ++ks) { const int s = 16 * st + fr, kd = 32 * ks + 8 * fq;
                  const v4u kw = *(const v4u*)(QKR + (size_t)(row0 + s) * 2048 + 512 + h * 128 + kd);
                  const float* bcp = BCUM + (size_t)(row0 + s) * 512 + h * 128 + kd; const f32x4 c0 = *(const f32x4*)bcp, c1 = *(const f32x4*)(bcp + 4);
                  v4u o; o.x = cvt_pk_bf16(bf_lo(kw.x) * __expf(-c0[0]), bf_hi(kw.x) * __expf(-c0[1])); o.y = cvt_pk_bf16(bf_lo(kw.y) * __expf(-c0[2]), bf_hi(kw.y) * __expf(-c0[3]));
                  o.z = cvt_pk_bf16(bf_lo(kw.z) * __expf(-c1[0]), bf_hi(kw.z) * __expf(-c1[1])); o.w = cvt_pk_bf16(bf_lo(kw.w) * __expf(-c1[2]), bf_hi(kw.w) * __expf(-c1[3]));
                  const bf16x8 qa = tt == 0 ? qf[0][ks] : tt == 1 ? qf[1][ks] : tt == 2 ? qf[2][ks] : qf[3][ks];
                  pacc = __builtin_amdgcn_mfma_f32_16x16x32_bf16(__builtin_bit_cast(bf16x8, o), qa, pacc, 0, 0, 0); }
              const int t = 16 * tt + fr, s0 = 16 * st + 4 * fq;
              v2u w; w.x = cvt_pk_bf16(s0 + 0 <= t ? pacc[0] : 0.f, s0 + 1 <= t ? pacc[1] : 0.f); w.y = cvt_pk_bf16(s0 + 2 <= t ? pacc[2] : 0.f, s0 + 3 <= t ? pacc[3] : 0.f);
              *(LAS v2u*)(Ps + t * 72 + s0) = w; } }
        __syncthreads();
        f32x4 acc[4][2];
#pragma unroll
        for (int tt = 0; tt < 4; ++tt) { acc[tt][0] = (f32x4){0.f, 0.f, 0.f, 0.f}; acc[tt][1] = (f32x4){0.f, 0.f, 0.f, 0.f}; }
#pragma unroll
        for (int ks = 0; ks < 4; ++ks) { bf16x8 sf[2];
#pragma unroll
            for (int nt = 0; nt < 2; ++nt) sf[nt] = *(const bf16x8*)(SST + (size_t)u * 32768 + (size_t)(32 * wave + 16 * nt + fr) * 128 + 32 * ks + 8 * fq);
#pragma unroll
            for (int tt = 0; tt < 4; ++tt)
#pragma unroll
                for (int nt = 0; nt < 2; ++nt) acc[tt][nt] = __builtin_amdgcn_mfma_f32_16x16x32_bf16(sf[nt], qf[tt][ks], acc[tt][nt], 0, 0, 0); }
#pragma unroll
        for (int k2 = 0; k2 < 2; ++k2) { bf16x8 vf[2];
#pragma unroll
            for (int nt = 0; nt < 2; ++nt) vf[nt] = *(const bf16x8*)(VT + (size_t)(h * 256 + 32 * wave + 16 * nt + fr) * M + row0 + 32 * k2 + 8 * fq);
#pragma unroll
            for (int tt = 0; tt < 4; ++tt) { const bf16x8 pf = *(const LAS bf16x8*)(Ps + (16 * tt + fr) * 72 + 32 * k2 + 8 * fq);
#pragma unroll
                for (int nt = 0; nt < 2; ++nt) acc[tt][nt] = __builtin_amdgcn_mfma_f32_16x16x32_bf16(vf[nt], pf, acc[tt][nt], 0, 0, 0); } }
#pragma unroll
        for (int tt = 0; tt < 4; ++tt) { float ss = 0.f;
#pragma unroll
            for (int nt = 0; nt < 2; ++nt) ss += (acc[tt][nt][0] * acc[tt][nt][0] + acc[tt][nt][1] * acc[tt][nt][1]) + (acc[tt][nt][2] * acc[tt][nt][2] + acc[tt][nt][3] * acc[tt][nt][3]);
            ss += __shfl_xor(ss, 16); ss += __shfl_xor(ss, 32);
            if (fq == 0) red[wave * 64 + 16 * tt + fr] = ss; }
        __syncthreads();
#pragma unroll
        for (int tt = 0; tt < 4; ++tt) { float tot = 0.f;
#pragma unroll
            for (int w = 0; w < 8; ++w) tot += red[w * 64 + 16 * tt + fr];
            const float rstd = 1.0f / sqrtf(tot * (1.0f / 256.0f) + LN_EPS);
#pragma unroll
            for (int nt = 0; nt < 2; ++nt) { const int vd = 32 * wave + 16 * nt + 4 * fq; const f32x4 ng = *(const f32x4*)(norm_g + vd);
                bf16* rp = QKR + (size_t)(row0 + 16 * tt + fr) * 2048 + 1024 + h * 256 + vd; const v2u rw = *(const v2u*)rp;
                const float r0 = bf_lo(rw.x), r1 = bf_hi(rw.x), r2 = bf_lo(rw.y), r3 = bf_hi(rw.y);
                v2u w; w.x = cvt_pk_bf16(acc[tt][nt][0] * rstd * ng[0] * r0 * sigm(r0), acc[tt][nt][1] * rstd * ng[1] * r1 * sigm(r1));
                w.y = cvt_pk_bf16(acc[tt][nt][2] * rstd * ng[2] * r2 * sigm(r2), acc[tt][nt][3] * rstd * ng[3] * r3 * sigm(r3));
                *(v2u*)rp = w; } }
        __syncthreads();
    }
}

__device__ __forceinline__ void lru_conv_phase(const bf16* XBR, bf16* XC, const float* cw, const float* cb, int gtid, int GT) {
    constexpr int NCG = LW / 8, RUN = 32;
    for (int task = gtid; task < (M / RUN) * NCG; task += GT) {
        const int cg = task % NCG, ch = cg * 8, t0 = (task / NCG) * RUN;
        float w0[8], w1[8], w2[8], w3[8], bs[8], p0[8], p1[8], p2[8];
#pragma unroll
        for (int i = 0; i < 8; ++i) { w0[i] = cw[ch + i]; w1[i] = cw[LW + ch + i]; w2[i] = cw[2 * LW + ch + i]; w3[i] = cw[3 * LW + ch + i]; bs[i] = cb[ch + i]; p0[i] = 0.f; p1[i] = 0.f; p2[i] = 0.f; }
        if ((t0 % SEQ) != 0) {
            const v4u a = *(const v4u*)(XBR + (size_t)(t0 - 3) * LW + ch), b = *(const v4u*)(XBR + (size_t)(t0 - 2) * LW + ch), c = *(const v4u*)(XBR + (size_t)(t0 - 1) * LW + ch);
            p0[0] = bf_lo(a.x); p0[1] = bf_hi(a.x); p0[2] = bf_lo(a.y); p0[3] = bf_hi(a.y); p0[4] = bf_lo(a.z); p0[5] = bf_hi(a.z); p0[6] = bf_lo(a.w); p0[7] = bf_hi(a.w);
            p1[0] = bf_lo(b.x); p1[1] = bf_hi(b.x); p1[2] = bf_lo(b.y); p1[3] = bf_hi(b.y); p1[4] = bf_lo(b.z); p1[5] = bf_hi(b.z); p1[6] = bf_lo(b.w); p1[7] = bf_hi(b.w);
            p2[0] = bf_lo(c.x); p2[1] = bf_hi(c.x); p2[2] = bf_lo(c.y); p2[3] = bf_hi(c.y); p2[4] = bf_lo(c.z); p2[5] = bf_hi(c.z); p2[6] = bf_lo(c.w); p2[7] = bf_hi(c.w);
        }
#pragma unroll 4
        for (int r = 0; r < RUN; ++r) {
            const v4u a = *(const v4u*)(XBR + (size_t)(t0 + r) * LW + ch);
            const float cur[8] = {bf_lo(a.x), bf_hi(a.x), bf_lo(a.y), bf_hi(a.y), bf_lo(a.z), bf_hi(a.z), bf_lo(a.w), bf_hi(a.w)};
            float o[8];
#pragma unroll
            for (int i = 0; i < 8; ++i) { o[i] = bs[i] + w0[i] * p0[i] + w1[i] * p1[i] + w2[i] * p2[i] + w3[i] * cur[i]; p0[i] = p1[i]; p1[i] = p2[i]; p2[i] = cur[i]; }
            v4u w; w.x = cvt_pk_bf16(o[0], o[1]); w.y = cvt_pk_bf16(o[2], o[3]); w.z = cvt_pk_bf16(o[4], o[5]); w.w = cvt_pk_bf16(o[6], o[7]);
            *(v4u*)(XC + (size_t)(t0 + r) * LW + ch) = w;
        }
    }
}

__device__ __forceinline__ void lru_scan_a(const bf16* LA, const bf16* BX, float* CAR, int gw, int NGW, int lane) {
    for (int task = gw; task < (M / 64) * 6; task += NGW) {
        const int cg = task % 6, bs = task / 6, ch = cg * 256 + lane * 4; const size_t base = (size_t)bs * 64 * LW + ch;
        float sl[4] = {0.f, 0.f, 0.f, 0.f}, H[4] = {0.f, 0.f, 0.f, 0.f};
        for (int r0 = 0; r0 < 64; r0 += 8) { v2u lw[8], bw[8];
#pragma unroll
            for (int i = 0; i < 8; ++i) { lw[i] = *(const v2u*)(LA + base + (size_t)(r0 + i) * LW); bw[i] = *(const v2u*)(BX + base + (size_t)(r0 + i) * LW); }
#pragma unroll
            for (int i = 0; i < 8; ++i) { const float l[4] = {bf_lo(lw[i].x), bf_hi(lw[i].x), bf_lo(lw[i].y), bf_hi(lw[i].y)}, x[4] = {bf_lo(bw[i].x), bf_hi(bw[i].x), bf_lo(bw[i].y), bf_hi(bw[i].y)};
#pragma unroll
                for (int q = 0; q < 4; ++q) { sl[q] += l[q]; H[q] = __expf(l[q]) * H[q] + x[q]; } } }
        float* cp = CAR + ((size_t)bs * LW + ch) * 2;
        *(f32x4*)cp = (f32x4){sl[0], H[0], sl[1], H[1]}; *(f32x4*)(cp + 4) = (f32x4){sl[2], H[2], sl[3], H[3]};
    }
}
__device__ __forceinline__ float gelu_tanh(float x) { return x * sigm(1.5957691216057308f * (x + 0.044715f * x * x * x)); }
__device__ __forceinline__ void lru_scan_b(const bf16* LA, const bf16* BX, const bf16* YBR, const float* CAR, bf16* YG, int gw, int NGW, int lane) {
    for (int task = gw; task < (M / 64) * 6; task += NGW) {
        const int cg = task % 6, bs = task / 6, ch = cg * 256 + lane * 4, seg = bs & 127, bq = bs >> 7; const size_t base = (size_t)bs * 64 * LW + ch;
        float H[4] = {0.f, 0.f, 0.f, 0.f};
        const float* cp = CAR + ((size_t)(bq * 128) * LW + ch) * 2;
#pragma unroll 4
        for (int j = 0; j < seg; ++j) { const f32x4 c0 = *(const f32x4*)(cp + (size_t)j * LW * 2), c1 = *(const f32x4*)(cp + (size_t)j * LW * 2 + 4);
            H[0] = __expf(c0[0]) * H[0] + c0[1]; H[1] = __expf(c0[2]) * H[1] + c0[3]; H[2] = __expf(c1[0]) * H[2] + c1[1]; H[3] = __expf(c1[2]) * H[3] + c1[3]; }
        for (int r0 = 0; r0 < 64; r0 += 8) { v2u lw[8], bw[8], yw[8];
#pragma unroll
            for (int i = 0; i < 8; ++i) { lw[i] = *(const v2u*)(LA + base + (size_t)(r0 + i) * LW); bw[i] = *(const v2u*)(BX + base + (size_t)(r0 + i) * LW); yw[i] = *(const v2u*)(YBR + base + (size_t)(r0 + i) * LW); }
#pragma unroll
            for (int i = 0; i < 8; ++i) { const float l[4] = {bf_lo(lw[i].x), bf_hi(lw[i].x), bf_lo(lw[i].y), bf_hi(lw[i].y)}, x[4] = {bf_lo(bw[i].x), bf_hi(bw[i].x), bf_lo(bw[i].y), bf_hi(bw[i].y)};
                const float y[4] = {bf_lo(yw[i].x), bf_hi(yw[i].x), bf_lo(yw[i].y), bf_hi(yw[i].y)}; float o[4];
#pragma unroll
                for (int q = 0; q < 4; ++q) { H[q] = __expf(l[q]) * H[q] + x[q]; o[q] = H[q] * gelu_tanh(y[q]); }
                v2u w; w.x = cvt_pk_bf16(o[0], o[1]); w.y = cvt_pk_bf16(o[2], o[3]); *(v2u*)(YG + base + (size_t)(r0 + i) * LW) = w; } }
    }
}

template <class Epi> __device__ __forceinline__ void run_gemm(LAS unsigned char* lds, const bf16* A, int lda, size_t agb, const bf16* Bt, int Mr, int N, int K, const Epi& E, int G) {
    pg8::Gemm g{A, Bt, Mr, N, K, lda, agb}; pg8::StaticOrder S; S.init(Mr, N, G, (int)blockIdx.x);
    pg8::gemm_phase<Epi, pg8::StaticOrder, true, true>(lds, g, S, E);
}

struct Args { const float* in[23]; float* out; unsigned char* ws; int ph_lo, ph_hi; };
enum { I_X = 0, I_P, I_LNG, I_LNB, I_FWI, I_FWO, I_GWI, I_GWGU, I_GBG, I_GNG, I_GWO, I_LWI, I_LCW, I_LCB, I_LWA, I_LBA, I_LWIG, I_LBI, I_LLAM, I_LWO, I_PWG, I_PBG, I_PWP };

#ifndef PH_MASK
#define PH_MASK 0xffffffffu
#endif
#define ON(n) (((PH_MASK) >> (n)) & 1u)
#define IN(k) (lo <= (k) && (k) < hi)
#define SEAM(k) do { if (IN(k) && IN((k) + 1)) grid.sync(); } while (0)
#define IDS() int tid = threadIdx.x; asm volatile("" : "+v"(tid)); const int lane = tid & 63, wave = __builtin_amdgcn_readfirstlane(tid >> 6); const int G = gridDim.x, gw = blockIdx.x * NWAVES + wave, NGW = G * NWAVES, gtid = blockIdx.x * NTHR + tid, GT = G * NTHR; (void)lane; (void)gw; (void)NGW; (void)gtid; (void)GT
template <int layer> __device__ __forceinline__ void layer_phases(const Args& args, LAS unsigned char* lds, cg::grid_group& grid, const int lo, const int hi) {
    unsigned char* ws = args.ws; float* X = args.out; bf16* XB = (bf16*)(ws + WS_XB);
        constexpr int pb = layer == 0 ? 1 : 14;
        const bf16* xin = layer == 0 ? XB : (const bf16*)(ws + S_XB2);
        if (IN(pb + 0) && ON(1)) { IDS(); { pg8::EpiSwiGLU E{(bf16*)(ws + S_ACT), FF}; run_gemm(lds, xin, D, 0, (const bf16*)(ws + WS_WIN) + (size_t)(layer * 2) * 2 * FF * D, M, 2 * FF, D, E, G); } }
        SEAM(pb + 0);
        if (IN(pb + 1) && ON(2)) { IDS(); { pg8::EpiResid E{layer == 0 ? args.in[I_X] : X, X, D, DN_ALPHA, 0.5f}; run_gemm(lds, (const bf16*)(ws + S_ACT), FF, 0, (const bf16*)(ws + WS_WOUT) + (size_t)(layer * 2) * D * FF, M, D, FF, E, G); } }
        SEAM(pb + 1);
        if (IN(pb + 2) && ON(3)) { IDS(); ln_phase(X, XB, args.in[I_LNG] + (layer * 3 + 0) * D, args.in[I_LNB] + (layer * 3 + 0) * D, gw, NGW, lane); }
        SEAM(pb + 2);
        int q = pb + 3;
        if (layer == 0) {
            if (IN(q)) { IDS();
                if (ON(4)) { pg8::EpiBf16<0> E{(bf16*)(ws + S_QKR), 2048, nullptr, 0, 0, 1.f}; run_gemm(lds, XB, D, 0, (const bf16*)(ws + WS_WG1), M, 2048, D, E, G); }
                if (ON(15)) { pg8::EpiBf16<0> E{(bf16*)(ws + S_VT), M, nullptr, 0, 0, 1.f}; run_gemm(lds, (const bf16*)(ws + WS_WV), D, 0, XB, 1024, M, D, E, G); }
                if (ON(5)) gla_gate_phase(XB, (const bf16*)(ws + WS_WZ), args.in[I_GWGU], args.in[I_GBG], (float*)(ws + S_BCUM), lds, tid, wave, lane, G);
            }
            SEAM(q); ++q;
            if (IN(q) && ON(6)) { IDS(); gla_local_phase((const bf16*)(ws + S_QKR), (const bf16*)(ws + S_VT), (const float*)(ws + S_BCUM), (bf16*)(ws + S_SL), lds, tid, wave, lane, G); }
            SEAM(q); ++q;
            if (IN(q) && ON(7)) { IDS(); gla_scan_phase((bf16*)(ws + S_SL), (const float*)(ws + S_BCUM), gtid, GT); }
            SEAM(q); ++q;
            if (IN(q) && ON(8)) { IDS(); gla_out_phase((bf16*)(ws + S_QKR), (const bf16*)(ws + S_VT), (const float*)(ws + S_BCUM), (const bf16*)(ws + S_SL), args.in[I_GNG], lds, tid, wave, lane, G); }
            SEAM(q); ++q;
            if (IN(q) && ON(2)) { IDS(); { pg8::EpiResid E{X, X, D, DN_ALPHA, 1.0f}; run_gemm(lds, (const bf16*)(ws + S_QKR) + 1024, 2048, 0, (const bf16*)(ws + WS_GWO), M, D, D, E, G); } }
            SEAM(q); ++q;
        } else {
            if (IN(q) && ON(9)) { IDS(); { pg8::EpiBf16<0> E{(bf16*)(ws + S_XBR), LW, nullptr, LW, (S_YBR - S_XBR) / 2, 1.f}; run_gemm(lds, XB, D, 0, (const bf16*)(ws + WS_LIN), M, 2 * LW, D, E, G); } }
            SEAM(q); ++q;
            if (IN(q) && ON(10)) { IDS(); lru_conv_phase((const bf16*)(ws + S_XBR), (bf16*)(ws + S_XC), args.in[I_LCW], args.in[I_LCB], gtid, GT); }
            SEAM(q); ++q;
            if (IN(q) && ON(11)) { IDS(); { pg8::EpiLruGate E{(const bf16*)(ws + S_XC), (bf16*)(ws + S_LA), (bf16*)(ws + S_XBR), args.in[I_LBA], args.in[I_LBI], args.in[I_LLAM], LW};
                run_gemm(lds, (const bf16*)(ws + S_XC), LW, 512, (const bf16*)(ws + WS_WGT), M, 2 * LW, 256, E, G); } }
            SEAM(q); ++q;
            if (IN(q) && ON(12)) { IDS(); lru_scan_a((const bf16*)(ws + S_LA), (const bf16*)(ws + S_XBR), (float*)(ws + S_CAR), gw, NGW, lane); }
            SEAM(q); ++q;
            if (IN(q) && ON(13)) { IDS(); lru_scan_b((const bf16*)(ws + S_LA), (const bf16*)(ws + S_XBR), (const bf16*)(ws + S_YBR), (const float*)(ws + S_CAR), (bf16*)(ws + S_XC), gw, NGW, lane); }
            SEAM(q); ++q;
            if (IN(q) && ON(2)) { IDS(); { pg8::EpiResid E{X, X, D, DN_ALPHA, 1.0f}; run_gemm(lds, (const bf16*)(ws + S_XC), LW, 0, (const bf16*)(ws + WS_LWO), M, D, LW, E, G); } }
            SEAM(q); ++q;
        }
        if (IN(q) && ON(3)) { IDS(); ln_phase(X, XB, args.in[I_LNG] + (layer * 3 + 1) * D, args.in[I_LNB] + (layer * 3 + 1) * D, gw, NGW, lane); }
        SEAM(q); ++q;
        if (IN(q) && ON(1)) { IDS(); { pg8::EpiSwiGLU E{(bf16*)(ws + S_ACT), FF}; run_gemm(lds, XB, D, 0, (const bf16*)(ws + WS_WIN) + (size_t)(layer * 2 + 1) * 2 * FF * D, M, 2 * FF, D, E, G); } }
        SEAM(q); ++q;
        if (IN(q) && ON(2)) { IDS(); { pg8::EpiResid E{X, X, D, DN_ALPHA, 0.5f}; run_gemm(lds, (const bf16*)(ws + S_ACT), FF, 0, (const bf16*)(ws + WS_WOUT) + (size_t)(layer * 2 + 1) * D * FF, M, D, FF, E, G); } }
        SEAM(q); ++q;
        if (IN(q) && ON(3)) { IDS(); ln_phase(X, XB, args.in[I_LNG] + (layer * 3 + 2) * D, args.in[I_LNB] + (layer * 3 + 2) * D, gw, NGW, lane); }
        SEAM(q); ++q;
        if (IN(q) && ON(14)) { IDS();
            { pg8::EpiF32 E{(float*)(ws + S_PP), D}; run_gemm(lds, (const bf16*)(ws + WS_PB) + (size_t)layer * M * DPLE, DPLE, 0, (const bf16*)(ws + WS_PPJ) + (size_t)layer * D * DPLE, M, D, DPLE, E, G); }
            { pg8::EpiPle E{X, (const float*)(ws + S_PP), args.in[I_PBG] + layer * D, layer == 0 ? (bf16*)(ws + S_XB2) : nullptr, D}; run_gemm(lds, XB, D, 0, (const bf16*)(ws + WS_PG) + (size_t)layer * D * D, M, D, D, E, G); }
        }
        if (layer == 0) SEAM(q);
    }

__global__ void __launch_bounds__(NTHR, 2) mk_fwd(Args args) {
    extern __shared__ __attribute__((aligned(16))) unsigned char lds_raw[];
    LAS unsigned char* lds = (LAS unsigned char*)lds_raw;
    cg::grid_group grid = cg::this_grid();
    unsigned char* ws = args.ws;
    float* X = args.out;
    bf16* XB = (bf16*)(ws + WS_XB);
    const int lo = args.ph_lo, hi = args.ph_hi;

    if (IN(0) && ON(0)) { IDS();
        LAS float* scr = (LAS float*)(lds + wave * 16384);
        for (int i = 0; i < 2; ++i) for (int s = 0; s < 2; ++s) {
            const float* wi = args.in[I_FWI] + (size_t)(i * 2 + s) * D * 2 * FF; bf16* wt = (bf16*)(ws + WS_WIN) + (size_t)(i * 2 + s) * 2 * FF * D;
            prep_mat<1>(wi, 2 * FF, D, FF, 0, wt, 0, scr, gw, NGW, lane); prep_mat<1>(wi, 2 * FF, D, FF, FF, wt, 128, scr, gw, NGW, lane);
            prep_mat<0>(args.in[I_FWO] + (size_t)(i * 2 + s) * FF * D, D, FF, D, 0, (bf16*)(ws + WS_WOUT) + (size_t)(i * 2 + s) * D * FF, 0, scr, gw, NGW, lane); }
        prep_mat<0>(args.in[I_GWI], GIN, D, 1024, 0, (bf16*)(ws + WS_WG1), 0, scr, gw, NGW, lane);
        prep_mat<0>(args.in[I_GWI], GIN, D, 1024, 2048, (bf16*)(ws + WS_WG1), 1024, scr, gw, NGW, lane);
        prep_mat<0>(args.in[I_GWI], GIN, D, 1024, 1024, (bf16*)(ws + WS_WV), 0, scr, gw, NGW, lane);
        for (int i = gtid; i < 16 * D; i += GT) { const int n = i >> 10, k = i & 1023; ((bf16*)(ws + WS_WZ))[i] = (bf16)(cvt_pk_bf16(args.in[I_GWI][(size_t)k * GIN + 3072 + n], 0.f) & 0xffffu); }
        prep_mat<0>(args.in[I_GWO], D, D, D, 0, (bf16*)(ws + WS_GWO), 0, scr, gw, NGW, lane);
        prep_mat<0>(args.in[I_LWI], 2 * LW, D, 2 * LW, 0, (bf16*)(ws + WS_LIN), 0, scr, gw, NGW, lane);
        for (int blk = 0; blk < 6; ++blk) {
            prep_mat<1>(args.in[I_LWA] + (size_t)blk * 65536, 256, 256, 256, 0, (bf16*)(ws + WS_WGT), blk * 512, scr, gw, NGW, lane);
            prep_mat<1>(args.in[I_LWIG] + (size_t)blk * 65536, 256, 256, 256, 0, (bf16*)(ws + WS_WGT), blk * 512 + 128, scr, gw, NGW, lane); }
        prep_mat<0>(args.in[I_LWO], D, LW, D, 0, (bf16*)(ws + WS_LWO), 0, scr, gw, NGW, lane);
        for (int i = 0; i < 2; ++i) {
            prep_mat<0>(args.in[I_PWG] + (size_t)i * D * D, D, D, D, 0, (bf16*)(ws + WS_PG) + (size_t)i * D * D, 0, scr, gw, NGW, lane);
            prep_mat<0>(args.in[I_PWP] + (size_t)i * DPLE * D, D, DPLE, D, 0, (bf16*)(ws + WS_PPJ) + (size_t)i * D * DPLE, 0, scr, gw, NGW, lane); }
        cvt_rows(args.in[I_X], XB, (size_t)M * D / 4, gtid, GT);
        cvt_rows(args.in[I_P], (bf16*)(ws + WS_PB), (size_t)2 * M * DPLE / 4, gtid, GT);
        __syncthreads();
    }
    SEAM(0);

    layer_phases<0>(args, lds, grid, lo, hi);
    layer_phases<1>(args, lds, grid, lo, hi);
#undef IN
#undef SEAM
}


__global__ void dump_k(const unsigned char* ws, float* out, size_t off0, int st0, int bf0, size_t off1, int st1, int bf1, size_t off2, int st2, int bf2, size_t off3, int st3, int bf3) {
    const size_t Q = (size_t)4 << 20;
    for (size_t i = blockIdx.x * (size_t)blockDim.x + threadIdx.x; i < 4 * Q; i += (size_t)gridDim.x * blockDim.x) {
        const int q = (int)(i / Q); const size_t j = i % Q;
        const size_t off = q == 0 ? off0 : q == 1 ? off1 : q == 2 ? off2 : off3; const int st = q == 0 ? st0 : q == 1 ? st1 : q == 2 ? st2 : st3; const int bf = q == 0 ? bf0 : q == 1 ? bf1 : q == 2 ? bf2 : bf3;
        float v; if (bf) v = __uint_as_float(((unsigned)((const unsigned short*)(ws + off))[j * st]) << 16); else v = ((const float*)(ws + off))[j * st];
        out[i] = v; }
}
extern "C" void kernel_launch(void* const* d_in, const int* in_sizes, int n_in, void* d_out, int out_size, void* d_ws, size_t ws_size, hipStream_t stream) {
    static int grid = 0;
    if (grid == 0) {
        if (n_in != 23 || in_sizes[0] != M * D || out_size != M * D || ws_size < WS_END) { fprintf(stderr, "kernel_launch: unexpected shapes: n_in %d in0 %d out %d ws %zu (need %zu)\n", n_in, n_in > 0 ? in_sizes[0] : -1, out_size, ws_size, (size_t)WS_END); grid = -1; return; }
        int dev = 0, cus = 0, per_cu = 0;
        hipGetDevice(&dev); hipDeviceGetAttribute(&cus, hipDeviceAttributeMultiprocessorCount, dev);
        if (hipFuncSetAttribute((const void*)mk_fwd, hipFuncAttributeMaxDynamicSharedMemorySize, LDS_BYTES) != hipSuccess) { fprintf(stderr, "kernel_launch: hipFuncSetAttribute failed\n"); grid = -1; return; }
        if (hipOccupancyMaxActiveBlocksPerMultiprocessor(&per_cu, (const void*)mk_fwd, NTHR, LDS_BYTES) != hipSuccess || per_cu < 1) { fprintf(stderr, "kernel_launch: occupancy query says %d\n", per_cu); per_cu = 1; }
        (void)hipGetLastError();
        grid = cus;
    }
    if (grid < 0) return;
    Args a{};
    for (int i = 0; i < 23; ++i) a.in[i] = (const float*)d_in[i];
    a.out = (float*)d_out; a.ws = (unsigned char*)d_ws;
#if MK_N_LAUNCHES == 1
    a.ph_lo = 0; a.ph_hi = N_PHASES;
    void* kargs[] = {&a};
    hipError_t e = hipLaunchCooperativeKernel((const void*)mk_fwd, dim3(grid), dim3(NTHR), kargs, LDS_BYTES, stream);
    if (e != hipSuccess) fprintf(stderr, "kernel_launch: cooperative launch failed: %s (grid %d)\n", hipGetErrorString(e), grid);
#else
#ifndef MK_STOP
#define MK_STOP N_PHASES
#endif
    for (int ph = 0; ph < MK_STOP; ++ph) { a.ph_lo = ph; a.ph_hi = ph + 1; hipLaunchKernelGGL(mk_fwd, dim3(grid), dim3(NTHR), LDS_BYTES, stream, a); }
#ifdef MK_DUMP
    hipLaunchKernelGGL(dump_k, dim3(2048), dim3(256), 0, stream, (const unsigned char*)d_ws, (float*)d_out, MK_DUMP);
#endif
#endif
}
```
